# Optimizing an MI355X kernel written in HIP

```python
import math
import jax, jax.numpy as jnp
from jax import lax
import numpy as np

D_MODEL = 1024
BATCH = 8
SEQ = 4096
DEPTH = 1

HEAD_DIM = 64
DILATED_GROUPS = ((128, 1), (512, 4), (2048, 16))
HEADS_PER_GROUP = 4
N_HEADS_A = HEADS_PER_GROUP * len(DILATED_GROUPS)
N_HEADS_B = 8
A_QKV = N_HEADS_A * HEAD_DIM
B_QKV = N_HEADS_B * HEAD_DIM
A_OUT = HEADS_PER_GROUP * HEAD_DIM
N_IN = 3 * A_QKV + 3 * B_QKV + 2 * D_MODEL
BLOCK = 128
NUM_BUCKETS = 32
MAX_DISTANCE = 2048
D_FF = 2816
CONV_WIDTH = 3
EPS = 1e-6

kernel_name = "hybrid_dilated_stickbreaking_block"


def rms_norm(x, g):
    xf = x.astype(jnp.float32)
    y = xf * lax.rsqrt(jnp.mean(xf * xf, axis=-1, keepdims=True) + EPS)
    return (y * g.astype(jnp.float32)).astype(x.dtype)


def t5_bucket(dist):
    max_exact = NUM_BUCKETS // 2
    n = np.asarray(dist, dtype=np.float32)
    large = max_exact + (np.log(np.maximum(n, 1.0) / max_exact)
                         / np.log(MAX_DISTANCE / max_exact)
                         * (NUM_BUCKETS - max_exact)).astype(np.int32)
    large = np.minimum(large, NUM_BUCKETS - 1)
    return np.where(n < max_exact, n.astype(np.int32), large).astype(np.int32)


def dilated_window_attention(q, k, v, bias, window, dilation):
    B, S, H, Dh = q.shape
    n_back = window // dilation
    unit = dilation * BLOCK
    Sp = -(-S // unit) * unit
    nb = Sp // unit

    def to_blocks(t):
        t = jnp.pad(t.astype(jnp.float32), ((0, 0), (0, Sp - S), (0, 0), (0, 0)))
        return t.reshape(B, nb, BLOCK, dilation, H, Dh)

    qb, kb, vb = to_blocks(q), to_blocks(k), to_blocks(v)

    def band(t):
        prev = jnp.concatenate([jnp.zeros_like(t[:, :1]), t[:, :-1]], axis=1)
        return jnp.concatenate([prev, t], axis=2)

    kband, vband = band(kb), band(vb)
    logits = jnp.einsum('bnirhe,bncrhe->bnrhic', qb, kband) * (1.0 / math.sqrt(Dh))

    i = np.arange(BLOCK)[:, None]
    c = np.arange(2 * BLOCK)[None, :]
    j = i + BLOCK - c
    local = (j >= 0) & (j <= n_back)
    key_m = np.arange(nb)[:, None, None] * BLOCK - BLOCK + c[None]
    mask = local[None] & (key_m >= 0)
    bias_band = bias.astype(jnp.float32)[:, np.clip(j, 0, n_back)]

    logits = jnp.where(mask[None, :, None, None], logits + bias_band[None, None, None], -jnp.inf)
    mx = jnp.max(logits, axis=-1, keepdims=True)
    e = jnp.exp(logits - mx)
    den = jnp.sum(e, axis=-1, keepdims=True)
    o = jnp.einsum('bnrhic,bncrhe->bnirhe', e, vband) / den.transpose(0, 1, 4, 2, 3, 5)
    lse = (mx + jnp.log(den))[..., 0].transpose(0, 1, 4, 2, 3)
    o = o.reshape(B, Sp, H, Dh)[:, :S]
    lse = lse.reshape(B, Sp, H)[:, :S]
    return o, lse


def stick_breaking_attention(q, k, v):
    B, S, H, Dh = q.shape
    nb = S // BLOCK
    kf = k.astype(jnp.float32)
    vf = v.astype(jnp.float32)
    qblocks = q.astype(jnp.float32).reshape(B, nb, BLOCK, H, Dh).transpose(1, 0, 2, 3, 4)
    pos_k = jnp.arange(S)

    def one_block(args):
        qblk, n = args
        z = jnp.einsum('bqhe,bkhe->bhqk', qblk, kf) * (1.0 / math.sqrt(Dh))
        t = n * BLOCK + jnp.arange(BLOCK)
        mask = pos_k[None, :] < t[:, None]
        log_beta = jax.nn.log_sigmoid(z)
        log_1m = jnp.where(mask, log_beta - z, 0.0)
        tail = lax.cumsum(log_1m, axis=3, reverse=True) - log_1m
        w = jnp.where(mask, jnp.exp(log_beta + tail), 0.0)
        return jnp.einsum('bhqk,bkhe->bqhe', w, vf)

    out = lax.map(one_block, (qblocks, jnp.arange(nb)))
    return out.transpose(1, 0, 2, 3, 4).reshape(B, S, H, Dh)


def setup_inputs(seed: int = 0) -> dict:
    key = jax.random.key(seed)
    ks = jax.random.split(key, 16)
    nrm = jax.random.normal
    x = nrm(ks[0], (BATCH, SEQ, D_MODEL), jnp.float32)
    g_pre_mix = 1.0 + 0.05 * nrm(ks[1], (DEPTH, D_MODEL), jnp.float32)
    w_in = nrm(ks[2], (DEPTH, D_MODEL, N_IN), jnp.float32) * D_MODEL ** -0.5
    rel_bias = 0.5 * nrm(ks[3], (NUM_BUCKETS, N_HEADS_A), jnp.float32)
    w_branch_a = nrm(ks[4], (DEPTH, A_OUT, D_MODEL), jnp.float32) * A_OUT ** -0.5
    w_branch_b = nrm(ks[5], (DEPTH, B_QKV, D_MODEL), jnp.float32) * B_QKV ** -0.5
    w_out = nrm(ks[6], (DEPTH, D_MODEL, D_MODEL), jnp.float32) * D_MODEL ** -0.5
    g_post_mix = 1.0 + 0.05 * nrm(ks[7], (DEPTH, D_MODEL), jnp.float32)
    g_pre_ffn = 1.0 + 0.05 * nrm(ks[8], (DEPTH, D_MODEL), jnp.float32)
    w_up = nrm(ks[9], (DEPTH, D_MODEL, 2 * D_FF), jnp.float32) * D_MODEL ** -0.5
    conv_w = nrm(ks[10], (DEPTH, CONV_WIDTH, 2 * D_FF), jnp.float32) * CONV_WIDTH ** -0.5
    conv_b = 0.02 * nrm(ks[11], (DEPTH, 2 * D_FF), jnp.float32)
    w_down = nrm(ks[12], (DEPTH, D_FF, D_MODEL), jnp.float32) * D_FF ** -0.5
    g_post_ffn = 1.0 + 0.05 * nrm(ks[13], (DEPTH, D_MODEL), jnp.float32)
    return {"x": x, "g_pre_mix": g_pre_mix, "w_in": w_in, "rel_bias": rel_bias,
            "w_branch_a": w_branch_a, "w_branch_b": w_branch_b, "w_out": w_out,
            "g_post_mix": g_post_mix, "g_pre_ffn": g_pre_ffn, "w_up": w_up,
            "conv_w": conv_w, "conv_b": conv_b, "w_down": w_down, "g_post_ffn": g_post_ffn}


def reference(x, g_pre_mix, w_in, rel_bias, w_branch_a, w_branch_b, w_out, g_post_mix,
              g_pre_ffn, w_up, conv_w, conv_b, w_down, g_post_ffn):
    B, S, D = x.shape
    splits = np.cumsum([A_QKV, A_QKV, A_QKV, B_QKV, B_QKV, B_QKV, D_MODEL]).tolist()
    for l in range(DEPTH):
        h = rms_norm(x, g_pre_mix[l])
        proj = h @ w_in[l]
        qa, ka, va, qb, kb, vb, gate_a, gate_b = jnp.split(proj, splits, axis=-1)
        qa = qa.reshape(B, S, N_HEADS_A, HEAD_DIM)
        ka = ka.reshape(B, S, N_HEADS_A, HEAD_DIM)
        va = va.reshape(B, S, N_HEADS_A, HEAD_DIM)
        qb = qb.reshape(B, S, N_HEADS_B, HEAD_DIM)
        kb = kb.reshape(B, S, N_HEADS_B, HEAD_DIM)
        vb = vb.reshape(B, S, N_HEADS_B, HEAD_DIM)

        outs, lses = [], []
        for g, (window, dilation) in enumerate(DILATED_GROUPS):
            sl = slice(g * HEADS_PER_GROUP, (g + 1) * HEADS_PER_GROUP)
            buckets = t5_bucket(np.arange(window // dilation + 1) * dilation)
            bias = rel_bias[buckets][:, sl].T
            o_g, lse_g = dilated_window_attention(qa[:, :, sl], ka[:, :, sl], va[:, :, sl],
                                                  bias, window, dilation)
            outs.append(o_g)
            lses.append(lse_g)
        wts = jax.nn.softmax(jnp.stack(lses, axis=0), axis=0)
        ya = jnp.sum(wts[..., None] * jnp.stack(outs, axis=0), axis=0).reshape(B, S, A_OUT)

        yb = stick_breaking_attention(qb, kb, vb).reshape(B, S, B_QKV)

        merged = (jax.nn.sigmoid(gate_a.astype(jnp.float32)) * (ya @ w_branch_a[l])
                  + jax.nn.sigmoid(gate_b.astype(jnp.float32)) * (yb @ w_branch_b[l]))
        x = x + rms_norm(merged @ w_out[l], g_post_mix[l]).astype(x.dtype)

        h = rms_norm(x, g_pre_ffn[l])
        u = h @ w_up[l]
        up = jnp.pad(u, ((0, 0), (CONV_WIDTH - 1, 0), (0, 0)))
        cw = conv_w[l]
        u = conv_b[l] + sum(cw[t] * up[:, t:t + S] for t in range(CONV_WIDTH))
        gate, val = jnp.split(u, 2, axis=-1)
        y = (jax.nn.gelu(gate.astype(jnp.float32), approximate=True) * val) @ w_down[l]
        x = x + rms_norm(y, g_post_ffn[l]).astype(x.dtype)
    return x
```

```cpp
#include <hip/hip_runtime.h>
#include <cstdio>
#include <cstdint>

constexpr int BATCH = 8, SEQ = 4096, DM = 1024, M = BATCH * SEQ;
constexpr int HD = 64, NHA = 12, NHB = 8, AQ = 768, BQ = 512, AOUT = 256;
constexpr int NIN = 5888, DFF = 2816, NUP = 5632;
constexpr float EPS = 1e-6f;
constexpr float LOG2E = 1.4426950408889634f, LN2 = 0.6931471805599453f;
constexpr float QSCALE = 0.125f * LOG2E;

typedef unsigned short bf16_t;
__device__ __forceinline__ unsigned f2bf(float f) { unsigned u = __builtin_bit_cast(unsigned, f); return (u + 0x7fffu + ((u >> 16) & 1u)) >> 16; }
__device__ __forceinline__ float bf2f(bf16_t b) { return __builtin_bit_cast(float, (unsigned)b << 16); }

__device__ const unsigned char BUCKET[3][129] = {
 {0,1,2,3,4,5,6,7,8,9,10,11,12,13,14,15,16,16,16,16,16,16,17,17,17,17,17,17,17,17,18,18,18,18,18,18,18,18,18,18,19,19,19,19,19,19,19,19,19,19,19,19,19,19,20,20,20,20,20,20,20,20,20,20,20,20,20,20,20,20,20,20,20,21,21,21,21,21,21,21,21,21,21,21,21,21,21,21,21,21,21,21,21,21,21,21,21,21,21,22,22,22,22,22,22,22,22,22,22,22,22,22,22,22,22,22,22,22,22,22,22,22,22,22,22,22,22,22,22},
 {0,4,8,12,16,16,17,17,18,18,19,19,19,19,20,20,20,20,20,21,21,21,21,21,21,22,22,22,22,22,22,22,22,22,23,23,23,23,23,23,23,23,23,23,23,23,24,24,24,24,24,24,24,24,24,24,24,24,24,24,24,24,25,25,25,25,25,25,25,25,25,25,25,25,25,25,25,25,25,25,25,25,25,26,26,26,26,26,26,26,26,26,26,26,26,26,26,26,26,26,26,26,26,26,26,26,26,26,26,26,26,26,26,27,27,27,27,27,27,27,27,27,27,27,27,27,27,27,27},
 {0,16,18,19,20,21,21,22,22,23,23,23,24,24,24,24,25,25,25,25,25,26,26,26,26,26,26,26,26,27,27,27,27,27,27,27,27,27,27,28,28,28,28,28,28,28,28,28,28,28,28,28,29,29,29,29,29,29,29,29,29,29,29,29,29,29,29,29,29,29,30,30,30,30,30,30,30,30,30,30,30,30,30,30,30,30,30,30,30,30,30,30,30,30,30,31,31,31,31,31,31,31,31,31,31,31,31,31,31,31,31,31,31,31,31,31,31,31,31,31,31,31,31,31,31,31,31,31,31}};

constexpr size_t MiB = 1u << 20;
constexpr size_t WS_CTL = 0;
constexpr size_t WS_XN = 48 * MiB;
constexpr size_t WS_GATES = 112 * MiB;
constexpr size_t WS_QKVA = 240 * MiB;
constexpr size_t WS_MG = 240 * MiB;
constexpr size_t WS_QKVB = 384 * MiB;
constexpr size_t WS_ACT = 288 * MiB;
constexpr size_t WS_UH = 112 * MiB;
constexpr size_t WS_Y2 = 112 * MiB;
constexpr size_t WS_END = 480 * MiB;

struct Params {
    const float *x, *g_pre_mix, *w_in, *rel_bias, *w_a, *w_b, *w_out, *g_post_mix, *g_pre_ffn, *w_up, *conv_w, *conv_b, *w_down, *g_post_ffn;
    float* out; unsigned char* ws;
};

__device__ __forceinline__ float wave_sum(float v) {
#pragma unroll
    for (int o = 1; o < 64; o <<= 1) v += __shfl_xor(v, o);
    return v;
}

__device__ void nv_rmsnorm_rows(const float* x, const float* g, bf16_t* o) {
    const int lane = threadIdx.x & 63, gw = (blockIdx.x * blockDim.x + threadIdx.x) >> 6, ngw = (gridDim.x * blockDim.x) >> 6;
    for (int r = gw; r < M; r += ngw) {
        const float* xr = x + (size_t)r * DM; float v[16]; float s = 0.f;
#pragma unroll
        for (int i = 0; i < 16; ++i) { v[i] = xr[lane + 64 * i]; s += v[i] * v[i]; }
        const float rstd = 1.0f / sqrtf(wave_sum(s) * (1.0f / DM) + EPS);
#pragma unroll
        for (int i = 0; i < 16; ++i) o[(size_t)r * DM + lane + 64 * i] = (bf16_t)f2bf(v[i] * rstd * g[lane + 64 * i]);
    }
}

template <class LA, class LB, class EP>
__device__ void nv_gemm(int Mrows, int N, int K, LA la, LB lb, EP ep, float* sm) {
    const int tid = threadIdx.x, ty = tid >> 4, tx = tid & 15;
    float* As = sm; float* Bs = sm + 16 * 132;
    const int ntn = N / 128, nt = (Mrows / 128) * ntn;
    for (int tile = blockIdx.x; tile < nt; tile += gridDim.x) {
        const int tm = tile / ntn, tn = tile % ntn;
        float acc[4][8];
#pragma unroll
        for (int i = 0; i < 4; ++i)
#pragma unroll
            for (int j = 0; j < 8; ++j) acc[i][j] = 0.f;
        for (int k0 = 0; k0 < K; k0 += 16) {
#pragma unroll
            for (int i = 0; i < 4; ++i) { const int e = tid + i * 512, r = e >> 4, kk = e & 15; As[kk * 132 + r] = la(tm * 128 + r, k0 + kk); }
#pragma unroll
            for (int i = 0; i < 4; ++i) { const int e = tid + i * 512, kk = e >> 7, c = e & 127; Bs[kk * 132 + c] = lb(k0 + kk, tn * 128 + c); }
            __syncthreads();
#pragma unroll
            for (int kk = 0; kk < 16; ++kk) {
                float a[4], b[8];
#pragma unroll
                for (int i = 0; i < 4; ++i) a[i] = As[kk * 132 + ty * 4 + i];
#pragma unroll
                for (int j = 0; j < 8; ++j) b[j] = Bs[kk * 132 + tx * 8 + j];
#pragma unroll
                for (int i = 0; i < 4; ++i)
#pragma unroll
                    for (int j = 0; j < 8; ++j) acc[i][j] = fmaf(a[i], b[j], acc[i][j]);
            }
            __syncthreads();
        }
#pragma unroll
        for (int i = 0; i < 4; ++i)
#pragma unroll
            for (int j = 0; j < 8; ++j) ep(tm * 128 + ty * 4 + i, tn * 128 + tx * 8 + j, acc[i][j]);
    }
}

__device__ void nv_p0(const Params& p) { nv_rmsnorm_rows(p.x, p.g_pre_mix, (bf16_t*)(p.ws + WS_XN)); }

__device__ void nv_p1(const Params& p, float* sm) {
    const bf16_t* A = (const bf16_t*)(p.ws + WS_XN); const float* W = p.w_in;
    bf16_t* qa = (bf16_t*)(p.ws + WS_QKVA); bf16_t* qb = (bf16_t*)(p.ws + WS_QKVB); bf16_t* gt = (bf16_t*)(p.ws + WS_GATES);
    nv_gemm(M, NIN, DM,
        [=](int r, int k) { return bf2f(A[(size_t)r * DM + k]); },
        [=](int k, int c) { return W[(size_t)k * NIN + c]; },
        [=](int r, int c, float v) {
            if (c < 2304) { if (c < 768) v *= QSCALE; qa[(size_t)r * 2304 + c] = (bf16_t)f2bf(v); }
            else if (c < 3840) { if (c < 2816) v *= QSCALE; qb[(size_t)r * 1536 + (c - 2304)] = (bf16_t)f2bf(v); }
            else { gt[(size_t)r * 2048 + (c - 3840)] = (bf16_t)f2bf(1.0f / (1.0f + __expf(-v))); }
        }, sm);
}

__device__ void nv_attn_a(const Params& p) {
    const int lane = threadIdx.x & 63, gw = (blockIdx.x * blockDim.x + threadIdx.x) >> 6, ngw = (gridDim.x * blockDim.x) >> 6;
    const bf16_t* QKV = (const bf16_t*)(p.ws + WS_QKVA); bf16_t* Y = (bf16_t*)(p.ws + WS_XN);
    for (int it = gw; it < M * 4; it += ngw) {
        const int row = it >> 2, s = it & 3, t = row % SEQ; const size_t rb = (size_t)(row - t);
        float m = -INFINITY, l = 0.f, acc = 0.f;
        for (int g = 0; g < 3; ++g) {
            const int dil = (g == 0) ? 1 : (g == 1) ? 4 : 16, h = g * 4 + s;
            const float q = bf2f(QKV[(size_t)row * 2304 + h * 64 + lane]);
            for (int j = 0; j <= 128; ++j) {
                const int tk = t - j * dil; if (tk < 0) break;
                const size_t kr = (rb + tk) * 2304;
                const float kv = bf2f(QKV[kr + 768 + h * 64 + lane]), vv = bf2f(QKV[kr + 1536 + h * 64 + lane]);
                const float z = wave_sum(q * kv) + p.rel_bias[BUCKET[g][j] * NHA + h] * LOG2E;
                const float mn = fmaxf(m, z), sc = exp2f(m - mn), pe = exp2f(z - mn);
                l = l * sc + pe; acc = acc * sc + pe * vv; m = mn;
            }
        }
        Y[(size_t)row * 768 + s * 64 + lane] = (bf16_t)f2bf(acc / l);
    }
}

__device__ void nv_attn_b(const Params& p) {
    const int lane = threadIdx.x & 63, gw = (blockIdx.x * blockDim.x + threadIdx.x) >> 6, ngw = (gridDim.x * blockDim.x) >> 6;
    const bf16_t* QKV = (const bf16_t*)(p.ws + WS_QKVB); bf16_t* Y = (bf16_t*)(p.ws + WS_XN);
    for (int it = gw; it < M * 8; it += ngw) {
        const int row = it >> 3, h = it & 7, t = row % SEQ; const size_t rb = (size_t)(row - t);
        const float q = bf2f(QKV[(size_t)row * 1536 + h * 64 + lane]);
        float tail = 0.f, acc = 0.f;
        for (int sk = t - 1; sk >= 0; --sk) {
            const size_t kr = (rb + sk) * 1536;
            const float kv = bf2f(QKV[kr + 512 + h * 64 + lane]), vv = bf2f(QKV[kr + 1024 + h * 64 + lane]);
            const float z = wave_sum(q * kv) * LN2;
            const float lb = fminf(z, 0.f) - log1pf(__expf(-fabsf(z)));
            acc += __expf(lb + tail) * vv; tail += lb - z;
        }
        Y[(size_t)row * 768 + 256 + h * 64 + lane] = (bf16_t)f2bf(acc);
    }
}

__device__ void nv_p3a(const Params& p, float* sm) {
    const bf16_t* A = (const bf16_t*)(p.ws + WS_XN); const float* W = p.w_a; const bf16_t* gt = (const bf16_t*)(p.ws + WS_GATES); float* T = p.out;
    nv_gemm(M, DM, 256, [=](int r, int k) { return bf2f(A[(size_t)r * 768 + k]); }, [=](int k, int c) { return W[(size_t)k * DM + c]; },
        [=](int r, int c, float v) { T[(size_t)r * DM + c] = v * bf2f(gt[(size_t)r * 2048 + c]); }, sm);
}
__device__ void nv_p3b(const Params& p, float* sm) {
    const bf16_t* A = (const bf16_t*)(p.ws + WS_XN); const float* W = p.w_b; const bf16_t* gt = (const bf16_t*)(p.ws + WS_GATES); const float* T = p.out;
    bf16_t* MG = (bf16_t*)(p.ws + WS_MG);
    nv_gemm(M, DM, 512, [=](int r, int k) { return bf2f(A[(size_t)r * 768 + 256 + k]); }, [=](int k, int c) { return W[(size_t)k * DM + c]; },
        [=](int r, int c, float v) { MG[(size_t)r * DM + c] = (bf16_t)f2bf(T[(size_t)r * DM + c] + v * bf2f(gt[(size_t)r * 2048 + 1024 + c])); }, sm);
}
__device__ void nv_p4a(const Params& p, float* sm) {
    const bf16_t* A = (const bf16_t*)(p.ws + WS_MG); const float* W = p.w_out; float* T = p.out;
    nv_gemm(M, DM, DM, [=](int r, int k) { return bf2f(A[(size_t)r * DM + k]); }, [=](int k, int c) { return W[(size_t)k * DM + c]; },
        [=](int r, int c, float v) { T[(size_t)r * DM + c] = v; }, sm);
}
__device__ void nv_norm_res(const float* y, const float* base, const float* g, float* o, const float* g2, bf16_t* xn) {
    const int lane = threadIdx.x & 63, gw = (blockIdx.x * blockDim.x + threadIdx.x) >> 6, ngw = (gridDim.x * blockDim.x) >> 6;
    for (int r = gw; r < M; r += ngw) {
        float v[16]; float s = 0.f;
#pragma unroll
        for (int i = 0; i < 16; ++i) { v[i] = y[(size_t)r * DM + lane + 64 * i]; s += v[i] * v[i]; }
        const float rstd = 1.0f / sqrtf(wave_sum(s) * (1.0f / DM) + EPS); float s2 = 0.f;
#pragma unroll
        for (int i = 0; i < 16; ++i) { v[i] = base[(size_t)r * DM + lane + 64 * i] + v[i] * rstd * g[lane + 64 * i]; s2 += v[i] * v[i]; }
#pragma unroll
        for (int i = 0; i < 16; ++i) o[(size_t)r * DM + lane + 64 * i] = v[i];
        if (xn) { const float r2 = 1.0f / sqrtf(wave_sum(s2) * (1.0f / DM) + EPS);
#pragma unroll
            for (int i = 0; i < 16; ++i) xn[(size_t)r * DM + lane + 64 * i] = (bf16_t)f2bf(v[i] * r2 * g2[lane + 64 * i]); }
    }
}
__device__ void nv_p5a(const Params& p, int half, float* sm) {
    const bf16_t* A = (const bf16_t*)(p.ws + WS_XN) + (size_t)half * (M / 2) * DM; const float* W = p.w_up; bf16_t* U = (bf16_t*)(p.ws + WS_UH);
    nv_gemm(M / 2, NUP, DM, [=](int r, int k) { return bf2f(A[(size_t)r * DM + k]); }, [=](int k, int c) { return W[(size_t)k * NUP + c]; },
        [=](int r, int c, float v) { U[(size_t)r * NUP + c] = (bf16_t)f2bf(v); }, sm);
}
__device__ __forceinline__ float gelu_tanh(float x) { const float u = 0.7978845608028654f * (x + 0.044715f * x * x * x); return 0.5f * x * (1.0f + tanhf(u)); }
__device__ void nv_p5b(const Params& p, int half) {
    const bf16_t* U = (const bf16_t*)(p.ws + WS_UH); bf16_t* ACT = (bf16_t*)(p.ws + WS_ACT) + (size_t)half * (M / 2) * DFF;
    const size_t n = (size_t)(M / 2) * DFF;
    for (size_t e = (size_t)blockIdx.x * blockDim.x + threadIdx.x; e < n; e += (size_t)gridDim.x * blockDim.x) {
        const int r = (int)(e / DFF), c = (int)(e % DFF), t = r % SEQ;
        float ug = p.conv_b[c], uv = p.conv_b[DFF + c];
#pragma unroll
        for (int tau = 0; tau < 3; ++tau) { const int tt = t - 2 + tau; if (tt >= 0) { const size_t rr = (size_t)(r - 2 + tau) * NUP;
            ug += p.conv_w[tau * NUP + c] * bf2f(U[rr + c]); uv += p.conv_w[tau * NUP + DFF + c] * bf2f(U[rr + DFF + c]); } }
        ACT[e] = (bf16_t)f2bf(gelu_tanh(ug) * uv);
    }
}
__device__ void nv_p6a(const Params& p, float* sm) {
    const bf16_t* A = (const bf16_t*)(p.ws + WS_ACT); const float* W = p.w_down; float* T = (float*)(p.ws + WS_Y2);
    nv_gemm(M, DM, DFF, [=](int r, int k) { return bf2f(A[(size_t)r * DFF + k]); }, [=](int k, int c) { return W[(size_t)k * DM + c]; },
        [=](int r, int c, float v) { T[(size_t)r * DM + c] = v; }, sm);
}

__global__ void __launch_bounds__(512) k_stage(Params p, int stage) {
    __shared__ float sm[2 * 16 * 132];
    switch (stage) {
        case 0: nv_p0(p); break;
        case 1: nv_p1(p, sm); break;
        case 2: nv_attn_a(p); break;
        case 3: nv_attn_b(p); break;
        case 4: nv_p3a(p, sm); break;
        case 5: nv_p3b(p, sm); break;
        case 6: nv_p4a(p, sm); break;
        case 7: nv_norm_res(p.out, p.x, p.g_post_mix, p.out, p.g_pre_ffn, (bf16_t*)(p.ws + WS_XN)); break;
        case 8: nv_p5a(p, 0, sm); break;
        case 9: nv_p5b(p, 0); break;
        case 10: nv_p5a(p, 1, sm); break;
        case 11: nv_p5b(p, 1); break;
        case 12: nv_p6a(p, sm); break;
        case 13: nv_norm_res((const float*)(p.ws + WS_Y2), p.out, p.g_post_ffn, p.out, nullptr, nullptr); break;
    }
}

extern "C" void kernel_launch(void* const* d_in, const int* in_sizes, int n_in, void* d_out, int out_size, void* d_ws, size_t ws_size, hipStream_t stream) {
    if (n_in != 14 || in_sizes[0] != M * DM || out_size != M * DM || ws_size < WS_END) {
        fprintf(stderr, "kernel_launch: unexpected shapes (n_in %d, in0 %d, out %d, ws %zu); nothing launched\n", n_in, n_in > 0 ? in_sizes[0] : -1, out_size, ws_size); return; }
    Params p{};
    p.x = (const float*)d_in[0]; p.g_pre_mix = (const float*)d_in[1]; p.w_in = (const float*)d_in[2]; p.rel_bias = (const float*)d_in[3];
    p.w_a = (const float*)d_in[4]; p.w_b = (const float*)d_in[5]; p.w_out = (const float*)d_in[6]; p.g_post_mix = (const float*)d_in[7];
    p.g_pre_ffn = (const float*)d_in[8]; p.w_up = (const float*)d_in[9]; p.conv_w = (const float*)d_in[10]; p.conv_b = (const float*)d_in[11];
    p.w_down = (const float*)d_in[12]; p.g_post_ffn = (const float*)d_in[13];
    p.out = (float*)d_out; p.ws = (unsigned char*)d_ws;
    for (int st = 0; st < 14; ++st) hipLaunchKernelGGL(k_stage, dim3(2048), dim3(512), 0, stream, p, st);
}
```
